# Optimizing an MI355X kernel written in HIP

```python
import jax, jax.numpy as jnp
from jax import lax
import numpy as np

D_MODEL = 1024
BATCH = 4
SEQ = 8192
DEPTH = 1

CHUNK = 64
N_PREV_CHUNKS = 8
BAND = (N_PREV_CHUNKS + 1) * CHUNK
ATT_HEADS = 8
ATT_HEAD_DIM = 64
ATT_WIDTH = ATT_HEADS * ATT_HEAD_DIM
REL_CLIP = 128
SG_BLOCK = 128
SG_GROUPS = 8
SG_GROUP_DIM = 64
SG_WIDTH = SG_GROUPS * SG_GROUP_DIM
N_BRANCHES = 2
IN_COLS = 3 * ATT_WIDTH + 2 * SG_WIDTH + N_BRANCHES * D_MODEL
MEM_LEN = 256
XATT_HEADS = 4
XATT_HEAD_DIM = D_MODEL // XATT_HEADS
D_FF = -(-8 * D_MODEL // (3 * 256)) * 256
EPS = 1e-6
NEG_INF = -1e30

kernel_name = "hybrid_chunk_attn_sgu_block"


def rmsnorm(x, g):
    xf = x.astype(jnp.float32)
    y = xf * lax.rsqrt(jnp.mean(xf * xf, axis=-1, keepdims=True) + EPS)
    return (y * g.astype(jnp.float32)).astype(x.dtype)


def layernorm(x, g, b):
    xf = x.astype(jnp.float32)
    mu = jnp.mean(xf, axis=-1, keepdims=True)
    var = jnp.mean(jnp.square(xf - mu), axis=-1, keepdims=True)
    y = (xf - mu) * lax.rsqrt(var + EPS)
    return (y * g.astype(jnp.float32) + b.astype(jnp.float32)).astype(x.dtype)


def chunked_relpos_attention(q, k, v, rel_bias):
    B, S, H, Dh = q.shape
    nC = S // CHUNK
    q = (q * (Dh ** -0.5)).reshape(B, nC, CHUNK, H, Dh)
    k = k.reshape(B, nC, CHUNK, H, Dh)
    v = v.reshape(B, nC, CHUNK, H, Dh)
    pad = ((0, 0), (N_PREV_CHUNKS, 0), (0, 0), (0, 0), (0, 0))
    kp = jnp.pad(k, pad)
    vp = jnp.pad(v, pad)
    kb = jnp.stack([kp[:, j:j + nC] for j in range(N_PREV_CHUNKS + 1)], axis=2).reshape(B, nC, BAND, H, Dh)
    vb = jnp.stack([vp[:, j:j + nC] for j in range(N_PREV_CHUNKS + 1)], axis=2).reshape(B, nC, BAND, H, Dh)
    s = jnp.einsum('bcihd,bcmhd->bhcim', q, kb, preferred_element_type=jnp.float32)
    qi = np.arange(CHUNK)[:, None]
    mi = np.arange(BAND)[None, :]
    dist = qi - mi + N_PREV_CHUNKS * CHUNK
    idx = np.clip(dist, -REL_CLIP, REL_CLIP) + REL_CLIP
    bias = rel_bias[:, idx].astype(jnp.float32)
    s = s + bias[None, :, None]
    valid = (np.arange(nC)[:, None] - N_PREV_CHUNKS + np.arange(BAND)[None, :] // CHUNK) >= 0
    s = jnp.where(valid[None, None, :, None, :], s, NEG_INF)
    p = jax.nn.softmax(s, axis=-1)
    o = jnp.einsum('bhcim,bcmhd->bcihd', p.astype(vb.dtype), vb)
    return o.reshape(B, S, H * Dh)


def spatial_gating(u, v, ln_g, ln_b, w_s, b_s):
    B, S, _ = u.shape
    nB = S // SG_BLOCK
    v = v.reshape(B, nB, SG_BLOCK, SG_GROUPS, SG_GROUP_DIM)
    v = layernorm(v, ln_g, ln_b)
    t = np.arange(SG_BLOCK)
    mask = (t[None, :] // CHUNK) <= (t[:, None] // CHUNK)
    w = jnp.where(mask[None], w_s, 0.0)
    sv = jnp.einsum('gts,bnsgd->bntgd', w, v) + b_s.T[None, None, :, :, None]
    return (u.reshape(B, nB, SG_BLOCK, SG_GROUPS, SG_GROUP_DIM) * sv).reshape(B, S, SG_WIDTH)


def cross_attention(h, m, w_xq, w_xkv, w_xo):
    B, S, _ = h.shape
    M = m.shape[1]
    q = (h @ w_xq).reshape(B, S, XATT_HEADS, XATT_HEAD_DIM) * (XATT_HEAD_DIM ** -0.5)
    k, v = jnp.split(m @ w_xkv, 2, axis=-1)
    k = k.reshape(B, M, XATT_HEADS, XATT_HEAD_DIM)
    v = v.reshape(B, M, XATT_HEADS, XATT_HEAD_DIM)
    s = jnp.einsum('bshd,bmhd->bhsm', q, k, preferred_element_type=jnp.float32)
    p = jax.nn.softmax(s, axis=-1)
    o = jnp.einsum('bhsm,bmhd->bshd', p.astype(v.dtype), v).reshape(B, S, D_MODEL)
    return o @ w_xo


def setup_inputs(seed: int = 0) -> dict:
    key = jax.random.key(seed)
    ks = jax.random.split(key, 24)
    f32 = jnp.float32
    nrm = lambda k, shape, scale: jax.random.normal(k, shape, f32) * scale
    L = DEPTH
    return {
        "x": nrm(ks[0], (BATCH, SEQ, D_MODEL), 1.0),
        "mem": nrm(ks[1], (BATCH, MEM_LEN, D_MODEL), 1.0),
        "norm_mix_g": 1.0 + nrm(ks[2], (L, D_MODEL), 0.02),
        "w_in": nrm(ks[3], (L, D_MODEL, IN_COLS), D_MODEL ** -0.5),
        "rel_bias": nrm(ks[4], (L, ATT_HEADS, 2 * REL_CLIP + 1), 0.5),
        "sg_ln_g": 1.0 + nrm(ks[5], (L, SG_GROUPS, SG_GROUP_DIM), 0.02),
        "sg_ln_b": nrm(ks[6], (L, SG_GROUPS, SG_GROUP_DIM), 0.02),
        "sg_w": nrm(ks[7], (L, SG_GROUPS, SG_BLOCK, SG_BLOCK), SG_BLOCK ** -0.5),
        "sg_b": 1.0 + nrm(ks[8], (L, SG_GROUPS, SG_BLOCK), 0.02),
        "w_branch_att": nrm(ks[9], (L, ATT_WIDTH, D_MODEL), ATT_WIDTH ** -0.5),
        "w_branch_sg": nrm(ks[10], (L, SG_WIDTH, D_MODEL), SG_WIDTH ** -0.5),
        "w_out": nrm(ks[11], (L, D_MODEL, D_MODEL), D_MODEL ** -0.5),
        "norm_xattn_g": 1.0 + nrm(ks[12], (L, D_MODEL), 0.02),
        "norm_mem_g": 1.0 + nrm(ks[13], (L, D_MODEL), 0.02),
        "w_xq": nrm(ks[14], (L, D_MODEL, D_MODEL), D_MODEL ** -0.5),
        "w_xkv": nrm(ks[15], (L, D_MODEL, 2 * D_MODEL), D_MODEL ** -0.5),
        "w_xo": nrm(ks[16], (L, D_MODEL, D_MODEL), D_MODEL ** -0.5),
        "norm_ffn_g": 1.0 + nrm(ks[17], (L, D_MODEL), 0.02),
        "w_ffn_in": nrm(ks[18], (L, D_MODEL, 2 * D_FF), D_MODEL ** -0.5),
        "w_ffn_out": nrm(ks[19], (L, D_FF, D_MODEL), D_FF ** -0.5),
        "norm_final_g": 1.0 + nrm(ks[20], (D_MODEL,), 0.02),
    }


def reference(x, mem, norm_mix_g, w_in, rel_bias, sg_ln_g, sg_ln_b, sg_w, sg_b,
              w_branch_att, w_branch_sg, w_out, norm_xattn_g, norm_mem_g,
              w_xq, w_xkv, w_xo, norm_ffn_g, w_ffn_in, w_ffn_out, norm_final_g):
    B, S, _ = x.shape
    col = np.cumsum([ATT_WIDTH, ATT_WIDTH, ATT_WIDTH, SG_WIDTH, SG_WIDTH, D_MODEL])
    for l in range(DEPTH):
        h = rmsnorm(x, norm_mix_g[l])
        z = h @ w_in[l]
        q, k, v, u_sg, v_sg, g_a, g_b = jnp.split(z, col, axis=-1)
        q = q.reshape(B, S, ATT_HEADS, ATT_HEAD_DIM)
        k = k.reshape(B, S, ATT_HEADS, ATT_HEAD_DIM)
        v = v.reshape(B, S, ATT_HEADS, ATT_HEAD_DIM)
        y_att = chunked_relpos_attention(q, k, v, rel_bias[l])
        y_sg = spatial_gating(jax.nn.gelu(u_sg), jax.nn.gelu(v_sg),
                              sg_ln_g[l], sg_ln_b[l], sg_w[l], sg_b[l])
        merged = (jax.nn.sigmoid(g_a) * (y_att @ w_branch_att[l])
                  + jax.nn.sigmoid(g_b) * (y_sg @ w_branch_sg[l]))
        x = x + merged @ w_out[l]
        x = x + cross_attention(rmsnorm(x, norm_xattn_g[l]), rmsnorm(mem, norm_mem_g[l]),
                                w_xq[l], w_xkv[l], w_xo[l])
        gate, up = jnp.split(rmsnorm(x, norm_ffn_g[l]) @ w_ffn_in[l], 2, axis=-1)
        x = x + (jax.nn.silu(gate) * up) @ w_ffn_out[l]
    return rmsnorm(x, norm_final_g)
```

```cpp
#include <hip/hip_runtime.h>
#include <math.h>
#include <stdint.h>

namespace {
constexpr int D = 1024, NB = 4, S = 8192, CH = 64, NPREV = 8, BAND = 576, AH = 8, AD = 64, AW = 512, RCLIP = 128;
constexpr int SGB = 128, SGG = 8, SGD = 64, SGW = 512, INC = 4608, ML = 256, XH = 4, XD = 256, DFF = 2816;
constexpr float EPS = 1e-6f;

__device__ __forceinline__ float gelu_tanh(float x) {
    const float c = 0.7978845608028654f;
    return 0.5f * x * (1.f + tanhf(c * (x + 0.044715f * x * x * x)));
}
__device__ __forceinline__ float sigmoidf(float x) { return 1.f / (1.f + expf(-x)); }
__device__ __forceinline__ float wave_sum(float v) {
#pragma unroll
    for (int o = 1; o < 64; o <<= 1) v += __shfl_xor(v, o);
    return v;
}
__device__ __forceinline__ float wave_max(float v) {
#pragma unroll
    for (int o = 1; o < 64; o <<= 1) v = fmaxf(v, __shfl_xor(v, o));
    return v;
}

__global__ void __launch_bounds__(256) k_rmsnorm(const float* __restrict__ x, const float* __restrict__ g, float* __restrict__ out) {
    __shared__ float red[4];
    const size_t row = blockIdx.x;
    const float4 v = ((const float4*)(x + row * D))[threadIdx.x];
    float s = v.x * v.x + v.y * v.y + v.z * v.z + v.w * v.w;
    s = wave_sum(s);
    if ((threadIdx.x & 63) == 0) red[threadIdx.x >> 6] = s;
    __syncthreads();
    const float tot = red[0] + red[1] + red[2] + red[3];
    const float r = rsqrtf(tot * (1.f / D) + EPS);
    const float4 gg = ((const float4*)g)[threadIdx.x];
    float4 o; o.x = v.x * r * gg.x; o.y = v.y * r * gg.y; o.z = v.z * r * gg.z; o.w = v.w * r * gg.w;
    ((float4*)(out + row * D))[threadIdx.x] = o;
}

__global__ void __launch_bounds__(256) k_gemm(const float* __restrict__ A, int lda, const float* __restrict__ Bm, int ldb, float* C, int ldc,
                                              int K, const float* R, int ldr) {
    __shared__ float As[16][128 + 4];
    __shared__ float Bs[16][128 + 4];
    const int tid = threadIdx.x, tx = tid & 15, ty = tid >> 4;
    const int m0 = blockIdx.y * 128, n0 = blockIdx.x * 128;
    float acc[8][8];
#pragma unroll
    for (int i = 0; i < 8; ++i)
#pragma unroll
        for (int j = 0; j < 8; ++j) acc[i][j] = 0.f;
    for (int k0 = 0; k0 < K; k0 += 16) {
#pragma unroll
        for (int i = 0; i < 2; ++i) {
            const int e = tid + i * 256;
            const int r = e >> 2, c4 = (e & 3) * 4;
            const float4 v = *(const float4*)(A + (size_t)(m0 + r) * lda + k0 + c4);
            As[c4 + 0][r] = v.x; As[c4 + 1][r] = v.y; As[c4 + 2][r] = v.z; As[c4 + 3][r] = v.w;
        }
#pragma unroll
        for (int i = 0; i < 2; ++i) {
            const int e = tid + i * 256;
            const int r = e >> 5, c4 = (e & 31) * 4;
            const float4 v = *(const float4*)(Bm + (size_t)(k0 + r) * ldb + n0 + c4);
            *(float4*)&Bs[r][c4] = v;
        }
        __syncthreads();
#pragma unroll
        for (int k = 0; k < 16; ++k) {
            float a[8], b[8];
            *(float4*)&a[0] = *(const float4*)&As[k][ty * 4];
            *(float4*)&a[4] = *(const float4*)&As[k][64 + ty * 4];
            *(float4*)&b[0] = *(const float4*)&Bs[k][tx * 4];
            *(float4*)&b[4] = *(const float4*)&Bs[k][64 + tx * 4];
#pragma unroll
            for (int i = 0; i < 8; ++i)
#pragma unroll
                for (int j = 0; j < 8; ++j) acc[i][j] = fmaf(a[i], b[j], acc[i][j]);
        }
        __syncthreads();
    }
#pragma unroll
    for (int i = 0; i < 8; ++i) {
        const int r = m0 + (i < 4 ? ty * 4 + i : 64 + ty * 4 + (i - 4));
#pragma unroll
        for (int jh = 0; jh < 2; ++jh) {
            const int c = n0 + jh * 64 + tx * 4;
            float4 o; o.x = acc[i][jh * 4 + 0]; o.y = acc[i][jh * 4 + 1]; o.z = acc[i][jh * 4 + 2]; o.w = acc[i][jh * 4 + 3];
            if (R) { const float4 rr = *(const float4*)(R + (size_t)r * ldr + c); o.x += rr.x; o.y += rr.y; o.z += rr.z; o.w += rr.w; }
            *(float4*)(C + (size_t)r * ldc + c) = o;
        }
    }
}

__global__ void __launch_bounds__(256) k_attn(const float* __restrict__ z, const float* __restrict__ rel_bias, float* __restrict__ y) {
    __shared__ float ps[4][BAND];
    __shared__ float qs[4][AD];
    const int c = blockIdx.x, h = blockIdx.y, w = threadIdx.x >> 6, l = threadIdx.x & 63;
    const float* bias = rel_bias + h * (2 * RCLIP + 1);
    for (int qi = w * 16; qi < w * 16 + 16; ++qi) {
        const int t = c * CH + qi;
        qs[w][l] = z[(size_t)t * INC + h * AD + l] * 0.125f;
        __builtin_amdgcn_wave_barrier();
        float sc[9]; float mx = -3.0e38f;
#pragma unroll
        for (int j = 0; j < 9; ++j) {
            const int kc = c - NPREV + j, m = j * 64 + l;
            float s;
            if (kc >= 0) {
                const float* kr = z + (size_t)(kc * CH + l) * INC + AW + h * AD;
                s = 0.f;
#pragma unroll 8
                for (int d = 0; d < AD; ++d) s = fmaf(qs[w][d], kr[d], s);
                int dist = qi - m + NPREV * CH;
                dist = dist < -RCLIP ? -RCLIP : (dist > RCLIP ? RCLIP : dist);
                s += bias[dist + RCLIP];
            } else s = -1e30f;
            sc[j] = s; mx = fmaxf(mx, s);
        }
        mx = wave_max(mx);
        float sum = 0.f;
#pragma unroll
        for (int j = 0; j < 9; ++j) { sc[j] = expf(sc[j] - mx); sum += sc[j]; }
        sum = wave_sum(sum);
        const float inv = 1.f / sum;
#pragma unroll
        for (int j = 0; j < 9; ++j) ps[w][j * 64 + l] = sc[j] * inv;
        __builtin_amdgcn_wave_barrier();
        float o = 0.f;
#pragma unroll 1
        for (int j = 0; j < 9; ++j) {
            const int kc = c - NPREV + j;
            if (kc < 0) continue;
            const float* vb = z + (size_t)(kc * CH) * INC + 2 * AW + h * AD + l;
#pragma unroll 8
            for (int mm = 0; mm < 64; ++mm) o = fmaf(ps[w][j * 64 + mm], vb[(size_t)mm * INC], o);
        }
        y[(size_t)t * AW + h * AD + l] = o;
        __builtin_amdgcn_wave_barrier();
    }
}

__global__ void __launch_bounds__(256) k_sgu(const float* __restrict__ z, const float* __restrict__ ln_g, const float* __restrict__ ln_b,
                                             const float* __restrict__ sgw, const float* __restrict__ sgb, float* __restrict__ y) {
    __shared__ float vln[SGB][SGD];
    const int nb = blockIdx.x, g = blockIdx.y, w = threadIdx.x >> 6, l = threadIdx.x & 63;
    for (int r = w * 32; r < w * 32 + 32; ++r) {
        const int t = nb * SGB + r;
        const float v = gelu_tanh(z[(size_t)t * INC + 3 * AW + SGW + g * SGD + l]);
        const float mu = wave_sum(v) * (1.f / SGD);
        const float dv = v - mu;
        const float var = wave_sum(dv * dv) * (1.f / SGD);
        vln[r][l] = dv * rsqrtf(var + EPS) * ln_g[g * SGD + l] + ln_b[g * SGD + l];
    }
    __syncthreads();
    for (int i = 0; i < 32; ++i) {
        const int tt = w * 32 + i, t = nb * SGB + tt;
        const int smax = (tt / CH + 1) * CH;
        const float* wr = sgw + ((size_t)g * SGB + tt) * SGB;
        float a = 0.f;
        for (int s = 0; s < smax; ++s) a = fmaf(wr[s], vln[s][l], a);
        const float sv = a + sgb[g * SGB + tt];
        const float u = gelu_tanh(z[(size_t)t * INC + 3 * AW + g * SGD + l]);
        y[(size_t)t * SGW + g * SGD + l] = u * sv;
    }
}

__global__ void __launch_bounds__(256) k_merge(const float* __restrict__ z, float* __restrict__ Pa, const float* __restrict__ Pb) {
    const size_t i = (size_t)blockIdx.x * 256 + threadIdx.x;
    const size_t t = i / D; const int c = (int)(i % D);
    const float ga = sigmoidf(z[t * INC + 3 * AW + 2 * SGW + c]), gb = sigmoidf(z[t * INC + 3 * AW + 2 * SGW + D + c]);
    Pa[i] = ga * Pa[i] + gb * Pb[i];
}

__global__ void __launch_bounds__(256) k_xattn(const float* __restrict__ q, const float* __restrict__ kv, float* __restrict__ o) {
    __shared__ float ps[4][ML];
    __shared__ float qs[4][XD];
    const int w = threadIdx.x >> 6, l = threadIdx.x & 63;
    const int gw = blockIdx.x * 4 + w, t = gw >> 2, h = gw & 3;
#pragma unroll
    for (int j = 0; j < 4; ++j) qs[w][l + 64 * j] = q[(size_t)t * D + h * XD + l + 64 * j] * 0.0625f;
    __builtin_amdgcn_wave_barrier();
    float sc[4]; float mx = -3.0e38f;
#pragma unroll
    for (int j = 0; j < 4; ++j) {
        const int m = l + 64 * j;
        const float* kr = kv + (size_t)m * (2 * D) + h * XD;
        float s = 0.f;
        for (int d = 0; d < XD; ++d) s = fmaf(qs[w][d], kr[d], s);
        sc[j] = s; mx = fmaxf(mx, s);
    }
    mx = wave_max(mx);
    float sum = 0.f;
#pragma unroll
    for (int j = 0; j < 4; ++j) { sc[j] = expf(sc[j] - mx); sum += sc[j]; }
    sum = wave_sum(sum);
    const float inv = 1.f / sum;
#pragma unroll
    for (int j = 0; j < 4; ++j) ps[w][l + 64 * j] = sc[j] * inv;
    __builtin_amdgcn_wave_barrier();
    float acc[4] = {0.f, 0.f, 0.f, 0.f};
    for (int m = 0; m < ML; ++m) {
        const float p = ps[w][m];
        const float* vr = kv + (size_t)m * (2 * D) + D + h * XD + l;
#pragma unroll
        for (int j = 0; j < 4; ++j) acc[j] = fmaf(p, vr[64 * j], acc[j]);
    }
#pragma unroll
    for (int j = 0; j < 4; ++j) o[(size_t)t * D + h * XD + l + 64 * j] = acc[j];
}

__global__ void __launch_bounds__(256) k_swiglu(const float* __restrict__ gu, float* __restrict__ hh) {
    const size_t i = (size_t)blockIdx.x * 256 + threadIdx.x;
    const size_t t = i / DFF; const int c = (int)(i % DFF);
    const float gt = gu[t * (2 * DFF) + c], up = gu[t * (2 * DFF) + DFF + c];
    hh[i] = gt * sigmoidf(gt) * up;
}

void gemm(hipStream_t st, const float* A, int lda, const float* Bm, int ldb, float* C, int ldc, int M, int N, int K, const float* R, int ldr) {
    hipLaunchKernelGGL(k_gemm, dim3(N / 128, M / 128), dim3(256), 0, st, A, lda, Bm, ldb, C, ldc, K, R, ldr);
}
}

extern "C" void kernel_launch(void* const* d_in, const int* in_sizes, int n_in, void* d_out, int out_size, void* d_ws, size_t ws_size, hipStream_t stream) {
    const float* x = (const float*)d_in[0]; const float* mem = (const float*)d_in[1]; const float* g_mix = (const float*)d_in[2];
    const float* w_in = (const float*)d_in[3]; const float* rel_bias = (const float*)d_in[4]; const float* ln_g = (const float*)d_in[5];
    const float* ln_b = (const float*)d_in[6]; const float* sgw = (const float*)d_in[7]; const float* sgb = (const float*)d_in[8];
    const float* w_ba = (const float*)d_in[9]; const float* w_bs = (const float*)d_in[10]; const float* w_out = (const float*)d_in[11];
    const float* g_xa = (const float*)d_in[12]; const float* g_mem = (const float*)d_in[13]; const float* w_xq = (const float*)d_in[14];
    const float* w_xkv = (const float*)d_in[15]; const float* w_xo = (const float*)d_in[16]; const float* g_ffn = (const float*)d_in[17];
    const float* w_fi = (const float*)d_in[18]; const float* w_fo = (const float*)d_in[19]; const float* g_fin = (const float*)d_in[20];
    float* out = (float*)d_out;
    const size_t MiB = 1u << 20;
    char* ws = (char*)d_ws;
    float* hbuf = (float*)(ws);
    float* zbuf = (float*)(ws + 32 * MiB);
    float* yatt = (float*)(ws + 208 * MiB);
    float* ysg = (float*)(ws + 224 * MiB);
    float* Pa = (float*)(ws + 240 * MiB);
    float* Pb = (float*)(ws + 272 * MiB);
    float* hh = (float*)(ws + 208 * MiB);
    float* memn = (float*)(ws + 304 * MiB);
    float* kvb = (float*)(ws + 305 * MiB);
    for (int b = 0; b < NB; ++b) {
        const float* xb = x + (size_t)b * S * D; float* ob = out + (size_t)b * S * D;
        hipLaunchKernelGGL(k_rmsnorm, dim3(S), dim3(256), 0, stream, xb, g_mix, hbuf);
        gemm(stream, hbuf, D, w_in, INC, zbuf, INC, S, INC, D, nullptr, 0);
        hipLaunchKernelGGL(k_attn, dim3(S / CH, AH), dim3(256), 0, stream, zbuf, rel_bias, yatt);
        hipLaunchKernelGGL(k_sgu, dim3(S / SGB, SGG), dim3(256), 0, stream, zbuf, ln_g, ln_b, sgw, sgb, ysg);
        gemm(stream, yatt, AW, w_ba, D, Pa, D, S, D, AW, nullptr, 0);
        gemm(stream, ysg, SGW, w_bs, D, Pb, D, S, D, SGW, nullptr, 0);
        hipLaunchKernelGGL(k_merge, dim3(S * D / 256), dim3(256), 0, stream, zbuf, Pa, Pb);
        gemm(stream, Pa, D, w_out, D, ob, D, S, D, D, xb, D);
        hipLaunchKernelGGL(k_rmsnorm, dim3(S), dim3(256), 0, stream, ob, g_xa, hbuf);
        hipLaunchKernelGGL(k_rmsnorm, dim3(ML), dim3(256), 0, stream, mem + (size_t)b * ML * D, g_mem, memn);
        gemm(stream, hbuf, D, w_xq, D, Pa, D, S, D, D, nullptr, 0);
        gemm(stream, memn, D, w_xkv, 2 * D, kvb, 2 * D, ML, 2 * D, D, nullptr, 0);
        hipLaunchKernelGGL(k_xattn, dim3(S), dim3(256), 0, stream, Pa, kvb, Pb);
        gemm(stream, Pb, D, w_xo, D, ob, D, S, D, D, ob, D);
        hipLaunchKernelGGL(k_rmsnorm, dim3(S), dim3(256), 0, stream, ob, g_ffn, hbuf);
        gemm(stream, hbuf, D, w_fi, 2 * DFF, zbuf, 2 * DFF, S, 2 * DFF, D, nullptr, 0);
        hipLaunchKernelGGL(k_swiglu, dim3((size_t)S * DFF / 256), dim3(256), 0, stream, zbuf, hh);
        gemm(stream, hh, DFF, w_fo, D, ob, D, S, D, DFF, ob, D);
        hipLaunchKernelGGL(k_rmsnorm, dim3(S), dim3(256), 0, stream, ob, g_fin, hbuf);
        (void)hipMemcpyAsync(ob, hbuf, (size_t)S * D * 4, hipMemcpyDeviceToDevice, stream);
    }
}
```

```cpp
#include <hip/hip_runtime.h>
#include <cstdio>
#include <cstdint>

#ifndef MK_PER_PHASE
#define MK_PER_PHASE 0
#endif

#define LAS __attribute__((address_space(3)))
#define GAS __attribute__((address_space(1)))
typedef unsigned short bf16;
typedef short bf16x8 __attribute__((ext_vector_type(8)));
typedef short s16x4 __attribute__((ext_vector_type(4)));
typedef float f32x4 __attribute__((ext_vector_type(4)));
typedef float f32x2 __attribute__((ext_vector_type(2)));
typedef float f32x16 __attribute__((ext_vector_type(16)));
typedef unsigned u32x4 __attribute__((ext_vector_type(4)));
typedef unsigned u32x2 __attribute__((ext_vector_type(2)));
typedef _Float16 h16x2 __attribute__((ext_vector_type(2)));

constexpr int NB = 4, SEQ = 8192, D = 1024, T = NB * SEQ;
constexpr int CH = 64, AH = 8, AW = 512, SGW = 512, INC = 4608, ML = 256, DFF = 2816;
constexpr float EPS = 1e-6f, LOG2E = 1.4426950408889634f;
constexpr float QSCALE = 0.125f * LOG2E;
constexpr float XSCALE = 0.0625f * LOG2E;

constexpr size_t MiB = 1u << 20;
constexpr size_t WS_CTL = 0, CTL_ZERO_BYTES = 1 * MiB;
constexpr size_t WS_SSQ1 = 1 * MiB, WS_SSQ2 = 3 * MiB, WS_SSQ3 = 5 * MiB;
constexpr size_t WS_WIN = 8 * MiB, WS_WXKV = 17 * MiB, WS_WA = 21 * MiB, WS_WB = 22 * MiB, WS_WOUT = 23 * MiB, WS_WQH = 25 * MiB, WS_WXOH = 27 * MiB,
                 WS_WFI = 29 * MiB, WS_WFO = 40 * MiB, WS_WSG = 46 * MiB, WS_MEMN = 47 * MiB, WS_KH = 49 * MiB, WS_VH = 51 * MiB, WS_WK = 53 * MiB, WS_VW = 61 * MiB;
constexpr size_t WS_RA = 72 * MiB;
constexpr size_t WS_RB = 136 * MiB;
constexpr size_t WS_RC = 232 * MiB;
constexpr size_t WS_RD = 296 * MiB;
constexpr size_t WS_H = 136 * MiB;
constexpr size_t WS_END = 424 * MiB;
constexpr int CW_TMO = 0, CW_BAR = 4096;

constexpr int RING_BYTES = 131072;
constexpr int XS_OFF = RING_BYTES;
constexpr int XS_RTAB = XS_OFF, XS_XCH = XS_OFF + 11264;
constexpr int MISC_OFF = XS_XCH + 8192;
constexpr int LDS_BYTES = MISC_OFF + 256;
static_assert(LDS_BYTES <= 163840, "LDS");

#define RLX_AGENT __ATOMIC_RELAXED, __HIP_MEMORY_SCOPE_AGENT
#define LDS_WAIT() asm volatile("s_waitcnt lgkmcnt(0)" ::: "memory")
#define VM_WAIT() asm volatile("s_waitcnt vmcnt(0)" ::: "memory")
__device__ __forceinline__ unsigned cvt_pk_bf16(float lo, float hi) { unsigned r; asm volatile("v_cvt_pk_bf16_f32 %0, %1, %2" : "=v"(r) : "v"(lo), "v"(hi)); return r; }
__device__ __forceinline__ float bf_lo(unsigned w) { return __uint_as_float(w << 16); }
__device__ __forceinline__ float bf_hi(unsigned w) { return __uint_as_float(w & 0xffff0000u); }
__device__ __forceinline__ unsigned pk_f16(float lo, float hi) { h16x2 v; v[0] = (_Float16)lo; v[1] = (_Float16)hi; return __builtin_bit_cast(unsigned, v); }
__device__ __forceinline__ float h_lo(unsigned w) { const h16x2 v = __builtin_bit_cast(h16x2, w); return (float)v[0]; }
__device__ __forceinline__ float h_hi(unsigned w) { const h16x2 v = __builtin_bit_cast(h16x2, w); return (float)v[1]; }
__device__ __forceinline__ float ex2(float x) { return __builtin_amdgcn_exp2f(x); }
__device__ __forceinline__ float rcp(float x) { return __builtin_amdgcn_rcpf(x); }
__device__ __forceinline__ float sigm(float x) { return rcp(1.f + ex2(-LOG2E * x)); }
__device__ __forceinline__ float gelu_t(float x) { const float u = x + 0.044715f * x * x * x; return x * rcp(1.f + ex2(-2.3022081983f * u)); }
__device__ __forceinline__ float wave_sum(float v) {
#pragma unroll
    for (int o = 1; o < 64; o <<= 1) v += __shfl_xor(v, o);
    return v;
}

namespace pg8 {
constexpr int BM = 256, BK = 64, HALF = 128, HTB = HALF * BK * 2, STAGE_BYTES = 8 * HTB;
__device__ __forceinline__ int lds_byte(int r, int c) { const int st = (r >> 4) * 2 + (c >> 5), rr = r & 15, cc = c & 31, ob = rr * 64 + cc * 2; return st * 1024 + (ob ^ (((ob >> 9) & 1) << 5)); }
__device__ __forceinline__ void stage_rc(int b, int& R, int& C) { const int st = b / 1024, sb = b % 1024, swz = sb ^ (((sb >> 9) & 1) << 5); R = (st >> 1) * 16 + swz / 64; C = (st & 1) * 32 + (swz % 64) / 2; }
__device__ __forceinline__ int perm32(int rho) { const int n = rho >> 4, i = rho & 15; return 8 * (i >> 2) + 4 * n + (i & 3); }

struct Unit { int pm, pn, kind, x0; const char* A; const char* B; };

__device__ __forceinline__ void tile_of(int L, int nM, int nN, int& pm, int& pn) {
    const int nwg = nM * nN; int wgid = L; { const int q = nwg / 8, r = nwg % 8, xcd = wgid % 8, off = wgid / 8; wgid = (xcd < r ? xcd * (q + 1) : r * (q + 1) + (xcd - r) * q) + off; }
    const int nig = 8 * nN, gid = wgid / nig, fm = gid * 8, gsz = (nM - fm) < 8 ? (nM - fm) : 8;
    pm = fm + ((wgid % nig) % gsz); pn = (wgid % nig) / gsz;
}

template <class Epi, class Sched>
__device__ __forceinline__ void gemm_phase(LAS unsigned char* lds, const int K, const Sched& S, const Epi& E) {
    const int tid = threadIdx.x, wid = __builtin_amdgcn_readfirstlane(tid >> 6), lane = tid & 63, wr = wid >> 2, wc = wid & 3, fr = lane & 15, fq = lane >> 4;
    const int nt = K / BK;
    unsigned voffA[2], voffB[2];
#pragma unroll
    for (int i = 0; i < 2; ++i) { int R, C; stage_rc(tid * 16 + i * 8192, R, C); const int Rb = (R & ~31) + perm32(R & 31);
        voffA[i] = (unsigned)(R * K + C) * 2u; voffB[i] = (unsigned)(Rb * K + C) * 2u; }
    const size_t kstep = (size_t)(BK * 2);
    const size_t hstep = (size_t)HALF * K * 2;
    const unsigned ldsw = (unsigned)wid * 1024u;
    const int aoff = lds_byte(wr * 64 + fr, fq * 8), boff = lds_byte(wc * 32 + fr, fq * 8);
#define PG8_SA(b, h) (((b) * 2 + (h)) * HTB)
#define PG8_SB(b, h) ((4 + (b) * 2 + (h)) * HTB)
#define PG8_STAGE(bufoff, gbase, voff) do { _Pragma("unroll") for (int _i = 0; _i < 2; ++_i) \
        __builtin_amdgcn_global_load_lds((const unsigned*)((const char*)(gbase) + (voff)[_i]), (LAS unsigned*)(lds + (bufoff) + ldsw + _i * 8192), 16, 0, 0); } while (0)
#define PG8_LDA(dst, b, h) do { _Pragma("unroll") for (int m = 0; m < 4; ++m) _Pragma("unroll") for (int k = 0; k < 2; ++k) dst[m][k] = *(const LAS bf16x8*)(lds + PG8_SA(b, h) + aoff + m * 2048 + k * 1024); } while (0)
#define PG8_LDB(dst, b, h) do { _Pragma("unroll") for (int n = 0; n < 2; ++n) _Pragma("unroll") for (int k = 0; k < 2; ++k) dst[n][k] = *(const LAS bf16x8*)(lds + PG8_SB(b, h) + boff + n * 2048 + k * 1024); } while (0)
#define PG8_MMA(ai, bj, At, Bt) do { __builtin_amdgcn_s_setprio(1); _Pragma("unroll") for (int m = 0; m < 4; ++m) _Pragma("unroll") for (int n = 0; n < 2; ++n) _Pragma("unroll") for (int k = 0; k < 2; ++k) \
        acc[ai][bj][m][n] = __builtin_amdgcn_mfma_f32_16x16x32_bf16(Bt[n][k], At[m][k], acc[ai][bj][m][n], 0, 0, 0); __builtin_amdgcn_s_setprio(0); } while (0)
#define PG8_WAIT_V(n) asm volatile("s_waitcnt vmcnt(" #n ")" ::: "memory")
#define PG8_WAIT_L(n) asm volatile("s_waitcnt lgkmcnt(" #n ")" ::: "memory")
#define PG8_BAR __builtin_amdgcn_s_barrier()
#define PG8_SCHED __builtin_amdgcn_sched_barrier(0)
    Unit cur, nxt; int ui = 0;
    if (!S.next(0, cur)) return;
    f32x4 acc[2][2][4][2];
#pragma unroll
    for (int a = 0; a < 2; ++a)
#pragma unroll
        for (int b = 0; b < 2; ++b)
#pragma unroll
            for (int m = 0; m < 4; ++m)
#pragma unroll
                for (int n = 0; n < 2; ++n) acc[a][b][m][n] = (f32x4){0.f, 0.f, 0.f, 0.f};
    bf16x8 At[4][2], B0[2][2], B1[2][2];
    const char* cA = cur.A; const char* cB = cur.B;
    PG8_STAGE(PG8_SB(0, 0), cB, voffB); PG8_STAGE(PG8_SB(0, 1), cB + hstep, voffB); PG8_STAGE(PG8_SA(0, 0), cA, voffA); PG8_STAGE(PG8_SA(0, 1), cA + hstep, voffA);
    if (wr == 1) PG8_BAR;
    PG8_WAIT_V(2); PG8_BAR;
    PG8_STAGE(PG8_SB(1, 0), cB + kstep, voffB); PG8_STAGE(PG8_SA(1, 0), cA + kstep, voffA); PG8_STAGE(PG8_SB(1, 1), cB + hstep + kstep, voffB);
    PG8_WAIT_V(6); PG8_BAR;
    for (;;) {
        const bool has_next = S.next(ui + 1, nxt);
        const char* nA = has_next ? nxt.A : cA; const char* nB = has_next ? nxt.B : cB;
        for (int t = 0; t < nt; t += 2) {
            const bool last = (t == nt - 2);
            const char* a1 = cA + (size_t)(t + 1) * kstep;
            const char* a2 = last ? nA : cA + (size_t)(t + 2) * kstep; const char* b2 = last ? nB : cB + (size_t)(t + 2) * kstep;
            const char* a3 = a2 + kstep; const char* b3 = b2 + kstep;
            PG8_LDB(B0, 0, 0); PG8_LDB(B1, 0, 1); PG8_SCHED; PG8_LDA(At, 0, 0); PG8_STAGE(PG8_SA(1, 1), a1 + hstep, voffA);
            PG8_WAIT_V(8); PG8_WAIT_L(0); PG8_BAR; PG8_MMA(0, 0, At, B0); PG8_MMA(0, 1, At, B1); PG8_BAR; PG8_SCHED;
            PG8_LDA(At, 0, 1); PG8_STAGE(PG8_SB(0, 0), b2, voffB); PG8_STAGE(PG8_SB(0, 1), b2 + hstep, voffB); PG8_STAGE(PG8_SA(0, 0), a2, voffA);
            PG8_WAIT_V(8); PG8_WAIT_L(0); PG8_BAR; PG8_MMA(1, 0, At, B0); PG8_MMA(1, 1, At, B1); PG8_BAR; PG8_SCHED;
            PG8_LDB(B0, 1, 0); PG8_LDB(B1, 1, 1); PG8_SCHED; PG8_LDA(At, 1, 0); PG8_STAGE(PG8_SA(0, 1), a2 + hstep, voffA);
            PG8_WAIT_V(8); PG8_WAIT_L(0); PG8_BAR; PG8_MMA(0, 0, At, B0); PG8_MMA(0, 1, At, B1); PG8_BAR; PG8_SCHED;
            PG8_LDA(At, 1, 1); PG8_STAGE(PG8_SB(1, 0), b3, voffB); PG8_STAGE(PG8_SB(1, 1), b3 + hstep, voffB); PG8_STAGE(PG8_SA(1, 0), a3, voffA);
            PG8_WAIT_V(8); PG8_WAIT_L(0); PG8_BAR; PG8_MMA(1, 0, At, B0); PG8_MMA(1, 1, At, B1); PG8_BAR; PG8_SCHED;
        }
        if (wr == 0) PG8_BAR;
        const bool keep = E.run(acc, cur, ui, wr, wc, fr, fq, wid, lane);
        if (!has_next) break;
        if (!keep) {
#pragma unroll
            for (int a = 0; a < 2; ++a)
#pragma unroll
                for (int b = 0; b < 2; ++b)
#pragma unroll
                    for (int m = 0; m < 4; ++m)
#pragma unroll
                        for (int n = 0; n < 2; ++n) acc[a][b][m][n] = (f32x4){0.f, 0.f, 0.f, 0.f};
        }
        cur = nxt; cA = nA; cB = nB; ++ui;
        if (wr == 1) PG8_BAR;
    }
    PG8_WAIT_V(0);
    PG8_BAR;
#undef PG8_SA
#undef PG8_SB
#undef PG8_STAGE
#undef PG8_LDA
#undef PG8_LDB
#undef PG8_MMA
#undef PG8_WAIT_V
#undef PG8_WAIT_L
#undef PG8_BAR
#undef PG8_SCHED
}
}
using pg8::Unit;
using pg8::tile_of;

#define EPI_ROWL(ai, m) ((ai) * 128 + wr * 64 + (m) * 16 + fr)
#define EPI_COLL(bj) ((bj) * 128 + wc * 32 + 8 * fq)
typedef f32x4 acc_t[2][2][4][2];

struct EpiP1 {
    bf16 *QKV, *UV, *GAB, *KVH;
    template <int ACT>
    __device__ __forceinline__ void tile(const acc_t& acc, bf16* base, int ldc, float sc, int wr, int wc, int fr, int fq) const {
#pragma unroll
        for (int ai = 0; ai < 2; ++ai)
#pragma unroll
            for (int m = 0; m < 4; ++m) { bf16* rowp = base + (size_t)EPI_ROWL(ai, m) * ldc + wc * 32 + 8 * fq;
#pragma unroll
                for (int bj = 0; bj < 2; ++bj) { f32x4 v0 = acc[ai][bj][m][0], v1 = acc[ai][bj][m][1]; u32x4 w;
                    if (ACT == 0) { v0 = v0 * sc; v1 = v1 * sc; }
                    if (ACT == 1) {
#pragma unroll
                        for (int j = 0; j < 4; ++j) { v0[j] = gelu_t(v0[j]); v1[j] = gelu_t(v1[j]); } }
                    if (ACT == 2) {
#pragma unroll
                        for (int j = 0; j < 4; ++j) { v0[j] = fmaxf(sigm(v0[j]), sc); v1[j] = fmaxf(sigm(v1[j]), sc); }
                        w.x = pk_f16(v0[0], v0[1]); w.y = pk_f16(v0[2], v0[3]); w.z = pk_f16(v1[0], v1[1]); w.w = pk_f16(v1[2], v1[3]);
                    } else { w.x = cvt_pk_bf16(v0[0], v0[1]); w.y = cvt_pk_bf16(v0[2], v0[3]); w.z = cvt_pk_bf16(v1[0], v1[1]); w.w = cvt_pk_bf16(v1[2], v1[3]); }
                    *(u32x4*)(rowp + bj * 128) = w; }
                asm volatile("" ::: "memory"); }
    }
    __device__ __forceinline__ bool run(acc_t& acc, const Unit& u, int ui, int wr, int wc, int fr, int fq, int wid, int lane) const {
        asm volatile("" : "+v"(fr), "+v"(fq));
        if (u.kind == 0) {
            const size_t r0 = (size_t)u.pm * 256; const int pn = u.pn;
            if (pn < 6) tile<0>(acc, QKV + (size_t)(pn >> 1) * ((size_t)T * 512) + r0 * 512 + (pn & 1) * 256, 512, pn < 2 ? QSCALE : 1.f, wr, wc, fr, fq);
            else if (pn < 10) tile<1>(acc, UV + (size_t)((pn - 6) >> 1) * ((size_t)T * 512) + r0 * 512 + (pn & 1) * 256, 512, 1.f, wr, wc, fr, fq);
            else tile<2>(acc, GAB + (size_t)((pn - 10) >> 2) * ((size_t)T * 1024) + r0 * 1024 + ((pn - 10) & 3) * 256, 1024, pn < 14 ? 0.f : 6.2e-5f, wr, wc, fr, fq);
        } else {
            tile<0>(acc, KVH + (size_t)(u.pn >> 2) * 1048576 + (size_t)(u.pm * 4 + (u.pn & 3)) * 65536, 256, 1.f, wr, wc, fr, fq);
        }
        return false;
    }
};

struct EpiStore {
    bf16* WK; bf16* VW;
    __device__ __forceinline__ bool run(acc_t& acc, const Unit& u, int ui, int wr, int wc, int fr, int fq, int wid, int lane) const {
        asm volatile("" : "+v"(fr), "+v"(fq));
        const int b = u.x0 >> 2, h = u.x0 & 3;
        bf16* base = u.kind == 0 ? WK + (size_t)b * 1048576 + (size_t)(h * 256) * 1024 + u.pn * 256 : VW + (size_t)b * 1048576 + (size_t)(u.pm * 256) * 1024 + h * 256;
#pragma unroll
        for (int ai = 0; ai < 2; ++ai)
#pragma unroll
            for (int m = 0; m < 4; ++m) { bf16* rowp = base + (size_t)EPI_ROWL(ai, m) * 1024 + wc * 32 + 8 * fq;
#pragma unroll
                for (int bj = 0; bj < 2; ++bj) { const f32x4 v0 = acc[ai][bj][m][0], v1 = acc[ai][bj][m][1]; u32x4 w;
                    w.x = cvt_pk_bf16(v0[0], v0[1]); w.y = cvt_pk_bf16(v0[2], v0[3]); w.z = cvt_pk_bf16(v1[0], v1[1]); w.w = cvt_pk_bf16(v1[2], v1[3]);
                    *(u32x4*)(rowp + bj * 128) = w; } }
        return false;
    }
};

struct EpiMerge {
    const bf16 *GA, *GB; bf16* MG;
    __device__ __forceinline__ bool run(acc_t& acc, const Unit& u, int ui, int wr, int wc, int fr, int fq, int wid, int lane) const {
        asm volatile("" : "+v"(fr), "+v"(fq));
        const size_t o0 = (size_t)u.pm * 256 * 1024 + u.pn * 256 + wc * 32 + 8 * fq;
#pragma unroll
        for (int ai = 0; ai < 2; ++ai)
#pragma unroll
            for (int m = 0; m < 4; ++m) { const size_t off = o0 + (size_t)EPI_ROWL(ai, m) * 1024;
#pragma unroll
                for (int bj = 0; bj < 2; ++bj) {
                    const u32x4 gb = *(const u32x4*)(GB + off + bj * 128);
                    const float b_[8] = {h_lo(gb.x), h_hi(gb.x), h_lo(gb.y), h_hi(gb.y), h_lo(gb.z), h_hi(gb.z), h_lo(gb.w), h_hi(gb.w)};
                    if (u.kind == 0) {
                        const u32x4 ga = *(const u32x4*)(GA + off + bj * 128);
                        const float a_[8] = {h_lo(ga.x), h_hi(ga.x), h_lo(ga.y), h_hi(ga.y), h_lo(ga.z), h_hi(ga.z), h_lo(ga.w), h_hi(ga.w)};
#pragma unroll
                        for (int j = 0; j < 4; ++j) { acc[ai][bj][m][0][j] *= a_[j] * rcp(b_[j]); acc[ai][bj][m][1][j] *= a_[4 + j] * rcp(b_[4 + j]); }
                    } else {
                        f32x4 v0 = acc[ai][bj][m][0], v1 = acc[ai][bj][m][1];
#pragma unroll
                        for (int j = 0; j < 4; ++j) { v0[j] *= b_[j]; v1[j] *= b_[4 + j]; }
                        u32x4 w; w.x = cvt_pk_bf16(v0[0], v0[1]); w.y = cvt_pk_bf16(v0[2], v0[3]); w.z = cvt_pk_bf16(v1[0], v1[1]); w.w = cvt_pk_bf16(v1[2], v1[3]);
                        *(u32x4*)(MG + off + bj * 128) = w;
                    } }
                if (m & 1) asm volatile("" ::: "memory"); }
        return u.kind == 0;
    }
};

template <bool XGOUT>
struct EpiX {
    const float* Xin; float* Xout; bf16* XG; const float* g; float* SSQ;
    __device__ __forceinline__ bool run(acc_t& acc, const Unit& u, int ui, int wr, int wc, int fr, int fq, int wid, int lane) const {
        asm volatile("" : "+v"(fr), "+v"(fq));
        const int col0 = u.pn * 256 + wc * 32 + 8 * fq;
        f32x4 gv[2][2];
        if (XGOUT) {
#pragma unroll
            for (int bj = 0; bj < 2; ++bj)
#pragma unroll
                for (int n = 0; n < 2; ++n) gv[bj][n] = *(const f32x4*)(g + col0 + bj * 128 + 4 * n);
        }
#pragma unroll
        for (int ai = 0; ai < 2; ++ai)
#pragma unroll
            for (int m = 0; m < 4; ++m) { const int row = u.pm * 256 + EPI_ROWL(ai, m); const size_t off = (size_t)row * 1024 + col0; float ss = 0.f;
#pragma unroll
                for (int bj = 0; bj < 2; ++bj) { f32x4 x1[2];
#pragma unroll
                    for (int n = 0; n < 2; ++n) { const f32x4 xi = *(const f32x4*)(Xin + off + bj * 128 + 4 * n); x1[n] = xi + acc[ai][bj][m][n];
                        *(f32x4*)(Xout + off + bj * 128 + 4 * n) = x1[n];
                        ss += (x1[n][0] * x1[n][0] + x1[n][1] * x1[n][1]) + (x1[n][2] * x1[n][2] + x1[n][3] * x1[n][3]); }
                    if (XGOUT) { const f32x4 a = x1[0] * gv[bj][0], b = x1[1] * gv[bj][1]; u32x4 w;
                        w.x = cvt_pk_bf16(a[0], a[1]); w.y = cvt_pk_bf16(a[2], a[3]); w.z = cvt_pk_bf16(b[0], b[1]); w.w = cvt_pk_bf16(b[2], b[3]);
                        *(u32x4*)(XG + off + bj * 128) = w; } }
                ss += __shfl_xor(ss, 16); ss += __shfl_xor(ss, 32);
                if (fq == 0) SSQ[(size_t)row * 16 + u.pn * 4 + wc] = ss;
                if (m & 1) asm volatile("" ::: "memory"); }
        return false;
    }
};

struct EpiSoftmax {
    bf16* P; LAS unsigned char* lds;
    __device__ __forceinline__ bool run(acc_t& acc, const Unit& u, int ui, int wr, int wc, int fr, int fq, int wid, int lane) const {
        asm volatile("" : "+v"(fr), "+v"(fq));
        const LAS float* rtab = (const LAS float*)(lds + XS_RTAB) + ui * 256;
        LAS f32x2* xch = (LAS f32x2*)(lds + XS_XCH);
        float mw[8];
#pragma unroll
        for (int ai = 0; ai < 2; ++ai)
#pragma unroll
            for (int m = 0; m < 4; ++m) { const int rl = EPI_ROWL(ai, m); const float rs = rtab[rl] * XSCALE; float mx = -3.0e38f;
#pragma unroll
                for (int bj = 0; bj < 2; ++bj)
#pragma unroll
                    for (int n = 0; n < 2; ++n) { f32x4 s = acc[ai][bj][m][n] * rs; acc[ai][bj][m][n] = s; mx = fmaxf(fmaxf(mx, fmaxf(s[0], s[1])), fmaxf(s[2], s[3])); }
                mx = fmaxf(mx, __shfl_xor(mx, 16)); mx = fmaxf(mx, __shfl_xor(mx, 32));
                float sum = 0.f;
#pragma unroll
                for (int bj = 0; bj < 2; ++bj)
#pragma unroll
                    for (int n = 0; n < 2; ++n) { f32x4 s = acc[ai][bj][m][n];
#pragma unroll
                        for (int j = 0; j < 4; ++j) { s[j] = ex2(s[j] - mx); sum += s[j]; }
                        acc[ai][bj][m][n] = s; }
                sum += __shfl_xor(sum, 16); sum += __shfl_xor(sum, 32);
                mw[ai * 4 + m] = mx;
                if (fq == 0) xch[rl * 4 + wc] = (f32x2){mx, sum}; }
        asm volatile("s_waitcnt lgkmcnt(0)" ::: "memory"); __builtin_amdgcn_s_barrier(); asm volatile("" ::: "memory");
        const size_t o0 = (size_t)u.pm * 256 * 1024 + u.pn * 256 + wc * 32 + 8 * fq;
#pragma unroll
        for (int ai = 0; ai < 2; ++ai)
#pragma unroll
            for (int m = 0; m < 4; ++m) { const int rl = EPI_ROWL(ai, m);
                const f32x4 p01 = *(const LAS f32x4*)(xch + rl * 4), p23 = *(const LAS f32x4*)(xch + rl * 4 + 2);
                const float M = fmaxf(fmaxf(p01[0], p01[2]), fmaxf(p23[0], p23[2]));
                const float L = (p01[1] * ex2(p01[0] - M) + p01[3] * ex2(p01[2] - M)) + (p23[1] * ex2(p23[0] - M) + p23[3] * ex2(p23[2] - M));
                const float f = ex2(mw[ai * 4 + m] - M) * rcp(L);
                bf16* rowp = P + o0 + (size_t)rl * 1024;
#pragma unroll
                for (int bj = 0; bj < 2; ++bj) { const f32x4 v0 = acc[ai][bj][m][0] * f, v1 = acc[ai][bj][m][1] * f; u32x4 w;
                    w.x = cvt_pk_bf16(v0[0], v0[1]); w.y = cvt_pk_bf16(v0[2], v0[3]); w.z = cvt_pk_bf16(v1[0], v1[1]); w.w = cvt_pk_bf16(v1[2], v1[3]);
                    *(u32x4*)(rowp + bj * 128) = w; } }
        return false;
    }
};

struct EpiSwiglu {
    bf16* H; LAS unsigned char* lds;
    __device__ __forceinline__ bool run(acc_t& acc, const Unit& u, int ui, int wr, int wc, int fr, int fq, int wid, int lane) const {
        asm volatile("" : "+v"(fr), "+v"(fq));
        const LAS float* rtab = (const LAS float*)(lds + XS_RTAB) + ui * 256;
#pragma unroll
        for (int ai = 0; ai < 2; ++ai)
#pragma unroll
            for (int m = 0; m < 4; ++m) { const int rl = EPI_ROWL(ai, m); const float rs = rtab[rl];
                f32x4 h[2];
#pragma unroll
                for (int n = 0; n < 2; ++n) { const f32x4 gt = acc[ai][0][m][n] * rs, up = acc[ai][1][m][n] * rs;
#pragma unroll
                    for (int j = 0; j < 4; ++j) h[n][j] = gt[j] * sigm(gt[j]) * up[j]; }
                u32x4 w; w.x = cvt_pk_bf16(h[0][0], h[0][1]); w.y = cvt_pk_bf16(h[0][2], h[0][3]); w.z = cvt_pk_bf16(h[1][0], h[1][1]); w.w = cvt_pk_bf16(h[1][2], h[1][3]);
                *(u32x4*)(H + (size_t)(u.pm * 256 + rl) * DFF + u.pn * 128 + wc * 32 + 8 * fq) = w; }
        return false;
    }
};

struct SchedP1 {
    int G, c; const char *XN, *WIN, *MEMN, *WXKV;
    __device__ __forceinline__ bool next(int i, Unit& u) const {
        const int L = i * G + c;
        if (L < 2304) { tile_of(L, 128, 18, u.pm, u.pn); u.kind = 0; u.x0 = 0; u.A = XN + (size_t)u.pm * 524288; u.B = WIN + (size_t)u.pn * 524288; return true; }
        const int r = L - 2304; if (r >= 32) return false;
        u.pm = r & 3; u.pn = r >> 2; u.kind = 1; u.x0 = 0; u.A = MEMN + (size_t)u.pm * 524288; u.B = WXKV + (size_t)u.pn * 524288; return true;
    }
};
struct SchedP2g {
    int c; const char *KH, *VH, *WQH, *WXOH;
    __device__ __forceinline__ bool next(int i, Unit& u) const {
        if (i > 0 || c >= 128) return false;
        const int r = c & 63, bh = r >> 2, q = r & 3, h = bh & 3; u.x0 = bh;
        if (c < 64) { u.kind = 0; u.pm = 0; u.pn = q; u.A = KH + (size_t)bh * 131072; u.B = WQH + (size_t)(h * 1024 + q * 256) * 512; }
        else { u.kind = 1; u.pm = q; u.pn = 0; u.A = WXOH + (size_t)(h * 1024 + q * 256) * 512; u.B = VH + (size_t)bh * 131072; }
        return true;
    }
};
struct SchedP3 {
    int G, c; const char *YA, *YS, *WA, *WB;
    __device__ __forceinline__ bool next(int i, Unit& u) const {
        const int L = (i >> 1) * G + c; if (L >= 512) return false;
        tile_of(L, 128, 4, u.pm, u.pn); u.kind = i & 1; u.x0 = 0;
        u.A = (u.kind ? YS : YA) + (size_t)u.pm * 262144; u.B = (u.kind ? WB : WA) + (size_t)u.pn * 262144; return true;
    }
};
struct SchedN4 {
    int G, c; const char *A, *B; size_t astep, bstep, bbatch;
    __device__ __forceinline__ bool next(int i, Unit& u) const {
        const int L = i * G + c; if (L >= 512) return false;
        tile_of(L, 128, 4, u.pm, u.pn); u.kind = 0; u.x0 = 0;
        u.A = A + (size_t)u.pm * astep; u.B = B + (size_t)(u.pm >> 5) * bbatch + (size_t)u.pn * bstep; return true;
    }
};
struct SchedP7 {
    int G, c; const char *A, *B;
    __device__ __forceinline__ bool next(int i, Unit& u) const {
        const int L = i * G + c; if (L >= 2816) return false;
        tile_of(L, 128, 22, u.pm, u.pn); u.kind = 0; u.x0 = 0;
        u.A = A + (size_t)u.pm * 524288; u.B = B + (size_t)u.pn * 524288; return true;
    }
};
template <class Sched>
__device__ __forceinline__ void fill_rstd(const Sched& S, const float* SSQ, LAS unsigned char* lds) {
    LAS float* tab = (LAS float*)(lds + XS_RTAB);
    const int tid = threadIdx.x;
    for (int i0 = 0; i0 < 11; i0 += 2) {
        Unit u; const int i = i0 + (tid >> 8);
        if (i < 11 && S.next(i, u)) {
            const f32x4* p = (const f32x4*)(SSQ + (size_t)(u.pm * 256 + (tid & 255)) * 16);
            const f32x4 a = p[0], b = p[1], c = p[2], d = p[3];
            const float s = ((a[0] + a[1]) + (a[2] + a[3])) + ((b[0] + b[1]) + (b[2] + b[3])) + ((c[0] + c[1]) + (c[2] + c[3])) + ((d[0] + d[1]) + (d[2] + d[3]));
            tab[i * 256 + (tid & 255)] = 1.0f / sqrtf(s * (1.f / D) + EPS);
        }
    }
    LDS_WAIT(); __syncthreads();
}

namespace att {
constexpr int KSTR = 144, KBUF = 64 * KSTR, VSTR = 192, VBUF = 64 * VSTR, O_K = 0, O_V = 2 * KBUF, O_BT = O_V + 2 * VBUF;
__device__ __forceinline__ int crow(int r, int hi) { return (r & 3) + 8 * (r >> 2) + 4 * hi; }
__device__ __forceinline__ s16x4 vtr(const LAS unsigned char* p) { typedef short v4i16_t __attribute__((ext_vector_type(4))); return __builtin_bit_cast(s16x4, __builtin_amdgcn_ds_read_tr16_b64_v4i16((LAS v4i16_t*)p)); }

__device__ __forceinline__ void unit(LAS unsigned char* lds, int b, int h, int qb, const bf16* Qb, const bf16* Kb, const bf16* Vb, const float* rel_bias, bf16* Y) {
    const int tid = threadIdx.x, lane = tid & 63, r32 = lane & 31, hi = lane >> 5; const int wid = __builtin_amdgcn_readfirstlane(tid >> 6);
    const int c0 = qb * 4, myc = c0 + (wid >> 1);
    const size_t tq = (size_t)b * SEQ + (size_t)qb * 256 + wid * 32 + r32;
    bf16x8 qf[4];
#pragma unroll
    for (int ks = 0; ks < 4; ++ks) qf[ks] = *(const bf16x8*)(Qb + tq * 512 + h * 64 + ks * 16 + hi * 8);
    LAS float* BT = (LAS float*)(lds + O_BT);
    if (tid < 257) BT[tid] = rel_bias[h * 257 + tid] * LOG2E;
    const int jlo = c0 - 8 > 0 ? c0 - 8 : 0, ntile = c0 + 4 - jlo;
    const int skr = tid >> 3, skc = tid & 7;
    const bf16* ksrc = Kb + ((size_t)b * SEQ + skr) * 512 + h * 64 + skc * 8;
    const bf16* vsrc = Vb + ((size_t)b * SEQ + skr) * 512 + h * 64 + skc * 8;
    const int kdst = O_K + skr * KSTR + skc * 16, vdst = O_V + skr * VSTR + skc * 16;
    u32x4 kreg = *(const u32x4*)(ksrc + (size_t)jlo * 64 * 512), vreg = *(const u32x4*)(vsrc + (size_t)jlo * 64 * 512);
    *(LAS u32x4*)(lds + kdst) = kreg; *(LAS u32x4*)(lds + vdst) = vreg;
    __syncthreads();
    float mrun = -1.0e30f, lrun = 0.f; f32x16 o[2];
#pragma unroll
    for (int r = 0; r < 16; ++r) { o[0][r] = 0.f; o[1][r] = 0.f; }
    const int qi = 32 * (wid & 1) + r32;
    const int vlane = ((lane & 15) >> 2) * VSTR + (16 * ((lane >> 4) & 1) + 4 * (lane & 3)) * 2;
    for (int t = 0; t < ntile; ++t) {
        const int j = jlo + t, buf = t & 1;
        if (t + 1 < ntile) { kreg = *(const u32x4*)(ksrc + (size_t)(j + 1) * 64 * 512); vreg = *(const u32x4*)(vsrc + (size_t)(j + 1) * 64 * 512); }
        const int delta = myc - j;
        if (delta >= 0 && delta <= 8) {
            const LAS unsigned char* Kt = lds + O_K + buf * KBUF; const LAS unsigned char* Vt = lds + O_V + buf * VBUF;
            const float cb = delta >= 3 ? BT[256] : 0.f;
            f32x16 p0, p1;
#pragma unroll
            for (int r = 0; r < 16; ++r) { p0[r] = cb; p1[r] = cb; }
#pragma unroll
            for (int ks = 0; ks < 4; ++ks) {
                const bf16x8 ka0 = *(const LAS bf16x8*)(Kt + r32 * KSTR + (ks * 16 + hi * 8) * 2);
                const bf16x8 ka1 = *(const LAS bf16x8*)(Kt + (32 + r32) * KSTR + (ks * 16 + hi * 8) * 2);
                p0 = __builtin_amdgcn_mfma_f32_32x32x16_bf16(ka0, qf[ks], p0, 0, 0, 0);
                p1 = __builtin_amdgcn_mfma_f32_32x32x16_bf16(ka1, qf[ks], p1, 0, 0, 0);
            }
            if (delta <= 2) {
                const int ib = 64 * delta + qi + 128;
#pragma unroll
                for (int r = 0; r < 16; ++r) { const int key = crow(r, hi); int i0 = ib - key, i1 = ib - key - 32; i0 = i0 > 256 ? 256 : i0; i1 = i1 > 256 ? 256 : i1; p0[r] += BT[i0]; p1[r] += BT[i1]; }
            }
            float mx = fmaxf(p0[0], p1[0]);
#pragma unroll
            for (int r = 1; r < 16; ++r) mx = fmaxf(mx, fmaxf(p0[r], p1[r]));
            mx = fmaxf(mx, __shfl_xor(mx, 32));
            const float mnew = fmaxf(mrun, mx), alpha = ex2(mrun - mnew);
            float rs = 0.f;
#pragma unroll
            for (int r = 0; r < 16; ++r) { p0[r] = ex2(p0[r] - mnew); p1[r] = ex2(p1[r] - mnew); rs += p0[r] + p1[r]; }
            lrun = lrun * alpha + rs; mrun = mnew;
#pragma unroll
            for (int r = 0; r < 16; ++r) { o[0][r] *= alpha; o[1][r] *= alpha; }
#pragma unroll
            for (int kh = 0; kh < 2; ++kh)
#pragma unroll
                for (int s = 0; s < 2; ++s) {
                    u32x4 pw;
                    if (kh == 0) { pw.x = cvt_pk_bf16(p0[8 * s + 0], p0[8 * s + 1]); pw.y = cvt_pk_bf16(p0[8 * s + 2], p0[8 * s + 3]); pw.z = cvt_pk_bf16(p0[8 * s + 4], p0[8 * s + 5]); pw.w = cvt_pk_bf16(p0[8 * s + 6], p0[8 * s + 7]); }
                    else { pw.x = cvt_pk_bf16(p1[8 * s + 0], p1[8 * s + 1]); pw.y = cvt_pk_bf16(p1[8 * s + 2], p1[8 * s + 3]); pw.z = cvt_pk_bf16(p1[8 * s + 4], p1[8 * s + 5]); pw.w = cvt_pk_bf16(p1[8 * s + 6], p1[8 * s + 7]); }
                    const bf16x8 pb = __builtin_bit_cast(bf16x8, pw);
                    const int r0 = 32 * kh + 16 * s + 4 * hi;
#pragma unroll
                    for (int dt = 0; dt < 2; ++dt) {
                        const s16x4 lo = vtr(Vt + r0 * VSTR + vlane + dt * 64), hh = vtr(Vt + (r0 + 8) * VSTR + vlane + dt * 64);
                        const bf16x8 va = (bf16x8){lo[0], lo[1], lo[2], lo[3], hh[0], hh[1], hh[2], hh[3]};
                        o[dt] = __builtin_amdgcn_mfma_f32_32x32x16_bf16(va, pb, o[dt], 0, 0, 0);
                    }
                }
        }
        if (t + 1 < ntile) { *(LAS u32x4*)(lds + kdst + (buf ^ 1) * KBUF) = kreg; *(LAS u32x4*)(lds + vdst + (buf ^ 1) * VBUF) = vreg; }
        __syncthreads();
    }
    const float ltot = lrun + __shfl_xor(lrun, 32), inv = 1.0f / ltot;
    bf16* yrow = Y + tq * 512 + h * 64;
#pragma unroll
    for (int dt = 0; dt < 2; ++dt)
#pragma unroll
        for (int g4 = 0; g4 < 4; ++g4) { u32x2 w; w.x = cvt_pk_bf16(o[dt][4 * g4 + 0] * inv, o[dt][4 * g4 + 1] * inv); w.y = cvt_pk_bf16(o[dt][4 * g4 + 2] * inv, o[dt][4 * g4 + 3] * inv);
            *(u32x2*)(yrow + 32 * dt + 8 * g4 + 4 * hi) = w; }
}
}

namespace sgu {
constexpr int TSTR = 272;
__device__ __forceinline__ void unit(LAS unsigned char* lds, int b, int nb, int g, const bf16* Ub, const bf16* VSb, const float* ln_g, const float* ln_b, const bf16* WSG, const float* sgb, bf16* Y) {
    const int tid = threadIdx.x, lane = tid & 63, r32 = lane & 31, hi = lane >> 5; const int wid = __builtin_amdgcn_readfirstlane(tid >> 6);
    const size_t tok0 = (size_t)b * SEQ + (size_t)nb * 128;
    {
        const int s = tid >> 2, qd = tid & 3;
        const u32x4* src = (const u32x4*)(VSb + (tok0 + s) * 512 + g * 64 + qd * 16);
        const u32x4 w0 = src[0], w1 = src[1];
        float v[16] = {bf_lo(w0.x), bf_hi(w0.x), bf_lo(w0.y), bf_hi(w0.y), bf_lo(w0.z), bf_hi(w0.z), bf_lo(w0.w), bf_hi(w0.w),
                       bf_lo(w1.x), bf_hi(w1.x), bf_lo(w1.y), bf_hi(w1.y), bf_lo(w1.z), bf_hi(w1.z), bf_lo(w1.w), bf_hi(w1.w)};
        float sm = 0.f;
#pragma unroll
        for (int i = 0; i < 16; ++i) sm += v[i];
        sm += __shfl_xor(sm, 1); sm += __shfl_xor(sm, 2);
        const float mu = sm * (1.f / 64.f); float q = 0.f;
#pragma unroll
        for (int i = 0; i < 16; ++i) { v[i] -= mu; q += v[i] * v[i]; }
        q += __shfl_xor(q, 1); q += __shfl_xor(q, 2);
        const float rstd = 1.0f / sqrtf(q * (1.f / 64.f) + EPS);
#pragma unroll
        for (int i = 0; i < 16; ++i) { const int d = qd * 16 + i; const float y = v[i] * rstd * ln_g[g * 64 + d] + ln_b[g * 64 + d];
            *(LAS bf16*)(lds + d * TSTR + s * 2) = (bf16)(cvt_pk_bf16(y, 0.f) & 0xffffu); }
    }
    LDS_WAIT(); __syncthreads();
    const int tt = wid >> 1, dt = wid & 1;
    f32x16 acc;
#pragma unroll
    for (int r = 0; r < 16; ++r) acc[r] = 0.f;
    const bf16* wrow = WSG + ((size_t)g * 128 + 32 * tt + r32) * 128 + hi * 8;
    const LAS unsigned char* arow = lds + (32 * dt + r32) * TSTR + hi * 16;
    const int nks = tt < 2 ? 4 : 8;
    for (int ks = 0; ks < nks; ++ks) {
        const bf16x8 wf = *(const bf16x8*)(wrow + ks * 16);
        const bf16x8 af = *(const LAS bf16x8*)(arow + ks * 32);
        acc = __builtin_amdgcn_mfma_f32_32x32x16_bf16(af, wf, acc, 0, 0, 0);
    }
    const int t = 32 * tt + r32; const float bs = sgb[g * 128 + t];
    const size_t ob = (tok0 + t) * 512 + g * 64 + 32 * dt + 4 * hi;
#pragma unroll
    for (int g4 = 0; g4 < 4; ++g4) { const u32x2 uw = *(const u32x2*)(Ub + ob + 8 * g4);
        const float y0 = bf_lo(uw.x) * (acc[4 * g4 + 0] + bs), y1 = bf_hi(uw.x) * (acc[4 * g4 + 1] + bs), y2 = bf_lo(uw.y) * (acc[4 * g4 + 2] + bs), y3 = bf_hi(uw.y) * (acc[4 * g4 + 3] + bs);
        u32x2 w; w.x = cvt_pk_bf16(y0, y1); w.y = cvt_pk_bf16(y2, y3); *(u32x2*)(Y + ob + 8 * g4) = w; }
    LDS_WAIT(); __syncthreads();
}
}

typedef GAS unsigned gu32;
#define XB_TMO      128
#define XB_XCNT(j)  (256  + 64 * (j))
#define XB_XSUB(j)  (1280 + 64 * (j))
#define XB_XGEN(j)  (2304 + 64 * (j))
#define XB_TOP      3328
#define XB_TOPGEN   3392
#define XCD_BAR_WORDS 3456
#define XB_SPIN_CAP (1u << 18)
__device__ __forceinline__ unsigned xb_ld(unsigned* p)              { return __hip_atomic_load(p, __ATOMIC_RELAXED, __HIP_MEMORY_SCOPE_AGENT); }
__device__ __forceinline__ unsigned xb_add(unsigned* p, unsigned v) { return __hip_atomic_fetch_add(p, v, __ATOMIC_RELAXED, __HIP_MEMORY_SCOPE_AGENT); }
__device__ __forceinline__ unsigned xb_xcc_id() { return (unsigned)__builtin_amdgcn_s_getreg((3 << 11) | 20) & 0xFu; }
#define XB_SPIN(cond, bar) do { unsigned _sp = 0; while (cond) { __builtin_amdgcn_s_sleep(1); \
    if ((++_sp & 255u) == 0u) { if (xb_ld(&(bar)[XB_TMO])) break; if (_sp > XB_SPIN_CAP) { atomicAdd(&(bar)[XB_TMO], 1u); break; } } } } while (0)
struct XcdBarrier { unsigned* bar; unsigned x; volatile LAS unsigned* st; };
__device__ __forceinline__ XcdBarrier xcd_barrier_post(unsigned* bar, volatile LAS unsigned* st) {
    XcdBarrier b; b.bar = bar; b.x = xb_xcc_id(); b.st = st;
    if (threadIdx.x == 0) (void)xb_add(&bar[XB_XCNT(b.x)], 1u);
    return b;
}
__device__ __forceinline__ void xcd_barrier_complete(unsigned* bar, unsigned x, unsigned& nloc, unsigned& nx) {
    const unsigned G = gridDim.x * gridDim.y * gridDim.z;
    unsigned sum, cnt, mine, sp = 0u;
    for (;;) {
        sum = 0u; cnt = 0u; mine = 0u;
#pragma unroll
        for (unsigned j = 0; j < 16; ++j) { const unsigned c = xb_ld(&bar[XB_XCNT(j)]); sum += c; cnt += (c > 0u) ? 1u : 0u; mine = (j == x) ? c : mine; }
        if (sum == G) break;
        __builtin_amdgcn_s_sleep(1);
        if ((++sp & 255u) == 0u) { if (xb_ld(&bar[XB_TMO])) break; if (sp > XB_SPIN_CAP) { atomicAdd(&bar[XB_TMO], 1u); break; } }
    }
    nloc = mine > 0u ? mine : 1u; nx = cnt > 0u ? cnt : 1u;
}
__device__ __forceinline__ void xcd_barrier(const XcdBarrier& b) {
    asm volatile("s_waitcnt vmcnt(0)" ::: "memory");
    __syncthreads();
    if (threadIdx.x == 0) {
        unsigned* bar = b.bar;
        __builtin_amdgcn_s_waitcnt(0);
        unsigned nloc = b.st[0], nx = b.st[1];
        if (nloc == 0u) { xcd_barrier_complete(bar, b.x, nloc, nx); b.st[0] = nloc; b.st[1] = nx; }
        const unsigned old = xb_add(&bar[XB_XSUB(b.x)], 1u);
        const unsigned gen = old / nloc;
        if (old + 1u == (gen + 1u) * nloc) {
            __builtin_amdgcn_fence(__ATOMIC_RELEASE, "agent");
            asm volatile("s_waitcnt vmcnt(0)" ::: "memory");
            const unsigned og = xb_add(&bar[XB_TOP], 1u);
            const unsigned tg = og / nx;
            if (og + 1u == (tg + 1u) * nx) xb_add(&bar[XB_TOPGEN], 1u);
            else XB_SPIN(xb_ld(&bar[XB_TOPGEN]) == tg, bar);
            __builtin_amdgcn_fence(__ATOMIC_ACQUIRE, "agent");
            xb_add(&bar[XB_XGEN(b.x)], 1u);
            asm volatile("s_waitcnt vmcnt(0)" ::: "memory");
        } else {
            XB_SPIN(xb_ld(&bar[XB_XGEN(b.x)]) == gen, bar);
            __builtin_amdgcn_fence(__ATOMIC_ACQUIRE, "agent");
            asm volatile("s_waitcnt vmcnt(0)" ::: "memory");
        }
    }
    __syncthreads();
}

__device__ __forceinline__ unsigned f2bf(float f) { unsigned u = __builtin_bit_cast(unsigned, f); return (u + 0x7fffu + ((u >> 16) & 1u)) >> 16; }
__device__ __forceinline__ unsigned pk2(float lo, float hi) { return f2bf(lo) | (f2bf(hi) << 16); }
__device__ __forceinline__ void transpose_block(const float* W, int K, int N, bf16* WT, int k0, int n0, int drow0, LAS float* scr, int lane) {
#pragma unroll 8
    for (int i = 0; i < 32; ++i) { const int kk = 2 * i + (lane >> 5); scr[kk * 33 + (lane & 31)] = W[(size_t)(k0 + kk) * N + n0 + (lane & 31)]; }
    LDS_WAIT(); asm volatile("" ::: "memory");
    const int c = lane & 7;
#pragma unroll
    for (int j = 0; j < 4; ++j) { const int n = (lane >> 3) + 8 * j; const LAS float* s = scr + (8 * c) * 33 + n;
        u32x4 o; o.x = pk2(s[0 * 33], s[1 * 33]); o.y = pk2(s[2 * 33], s[3 * 33]); o.z = pk2(s[4 * 33], s[5 * 33]); o.w = pk2(s[6 * 33], s[7 * 33]);
        *(GAS u32x4*)(WT + (size_t)(drow0 + n) * K + k0 + 8 * c) = o; }
    LDS_WAIT(); asm volatile("" ::: "memory");
}
__device__ __forceinline__ void rms_row_to_bf16(const float* xrow, const float* g, bf16* orow, int lane) {
    const GAS f32x4* xr = (const GAS f32x4*)xrow + lane; const GAS f32x4* gr = (const GAS f32x4*)g + lane;
    f32x4 v[4]; float s = 0.f;
#pragma unroll
    for (int j = 0; j < 4; ++j) { v[j] = xr[64 * j]; s += (v[j].x * v[j].x + v[j].y * v[j].y) + (v[j].z * v[j].z + v[j].w * v[j].w); }
    const float rstd = 1.f / sqrtf(wave_sum(s) * (1.f / D) + EPS);
    GAS unsigned long long* o8 = (GAS unsigned long long*)orow + lane;
#pragma unroll
    for (int j = 0; j < 4; ++j) { const f32x4 gg = gr[64 * j];
        o8[64 * j] = (unsigned long long)pk2(v[j].x * rstd * gg.x, v[j].y * rstd * gg.y) | ((unsigned long long)pk2(v[j].z * rstd * gg.z, v[j].w * rstd * gg.w) << 32); }
}

struct Args { const float* in[21]; float* out; unsigned char* ws; int ph_lo, ph_hi; };
constexpr int NPHASE = 10;

__global__ void __launch_bounds__(512, 2) mk_fwd(Args args) {
    extern __shared__ __attribute__((aligned(16))) unsigned char lds_raw[];
    LAS unsigned char* lds = (LAS unsigned char*)lds_raw;
    volatile LAS unsigned* MISC = (volatile LAS unsigned*)(lds + MISC_OFF);
    const int tid = threadIdx.x, lane = tid & 63; const int wave = __builtin_amdgcn_readfirstlane(tid >> 6);
    const int G = gridDim.x, bx = blockIdx.x, vcu = (G % 8 == 0) ? (bx % 8) * (G / 8) + bx / 8 : bx;
    unsigned char* ws = args.ws;
    gu32* ctl = (gu32*)(ws + WS_CTL);
    const float* x = args.in[0]; const float* mem = args.in[1]; const float* g_mix = args.in[2]; const float* w_in = args.in[3]; const float* rel_bias = args.in[4];
    const float* ln_g = args.in[5]; const float* ln_b = args.in[6]; const float* sg_w = args.in[7]; const float* sg_b = args.in[8]; const float* w_ba = args.in[9];
    const float* w_bs = args.in[10]; const float* w_out = args.in[11]; const float* g_xa = args.in[12]; const float* g_mem = args.in[13]; const float* w_xq = args.in[14];
    const float* w_xkv = args.in[15]; const float* w_xo = args.in[16]; const float* g_ffn = args.in[17]; const float* w_fi = args.in[18]; const float* w_fo = args.in[19];
    const float* g_fin = args.in[20];
    float* out = args.out;
    bf16* WIN = (bf16*)(ws + WS_WIN); bf16* WXKV = (bf16*)(ws + WS_WXKV); bf16* WA = (bf16*)(ws + WS_WA); bf16* WB = (bf16*)(ws + WS_WB); bf16* WOUT = (bf16*)(ws + WS_WOUT);
    bf16* WQH = (bf16*)(ws + WS_WQH); bf16* WXOH = (bf16*)(ws + WS_WXOH); bf16* WFI = (bf16*)(ws + WS_WFI); bf16* WFO = (bf16*)(ws + WS_WFO); bf16* WSG = (bf16*)(ws + WS_WSG);
    bf16* MEMN = (bf16*)(ws + WS_MEMN); bf16* KH = (bf16*)(ws + WS_KH); bf16* VH = (bf16*)(ws + WS_VH); bf16* WK = (bf16*)(ws + WS_WK); bf16* VW = (bf16*)(ws + WS_VW);
    bf16* XN = (bf16*)(ws + WS_RA); bf16* YA = (bf16*)(ws + WS_RA); bf16* YS = (bf16*)(ws + WS_RA + 32 * MiB); bf16* XG2 = (bf16*)(ws + WS_RA);
    bf16* Qb = (bf16*)(ws + WS_RB); bf16* Kb = (bf16*)(ws + WS_RB + 32 * MiB); bf16* Vb = (bf16*)(ws + WS_RB + 64 * MiB); bf16* MG = (bf16*)(ws + WS_RB);
    bf16* Ub = (bf16*)(ws + WS_RC); bf16* VSb = (bf16*)(ws + WS_RC + 32 * MiB); bf16* XG1 = (bf16*)(ws + WS_RC);
    bf16* GA = (bf16*)(ws + WS_RD); bf16* GB = (bf16*)(ws + WS_RD + 64 * MiB); bf16* PP = (bf16*)(ws + WS_RD);
    bf16* HB = (bf16*)(ws + WS_H);
    float* SSQ1 = (float*)(ws + WS_SSQ1); float* SSQ2 = (float*)(ws + WS_SSQ2); float* SSQ3 = (float*)(ws + WS_SSQ3);

    for (int u = tid; u < 64; u += 512) ((LAS unsigned*)(lds + MISC_OFF))[u] = 0u;
    __syncthreads();
    XcdBarrier bar; bar.bar = (unsigned*)(ctl + CW_BAR); bar.x = 0; bar.st = nullptr;
    if (!MK_PER_PHASE) bar = xcd_barrier_post((unsigned*)(ctl + CW_BAR), MISC + 8);
    const int lo = args.ph_lo, hi = args.ph_hi;
#ifndef MK_MASK
#define MK_MASK 0x3ff
#endif
#define IN(k) (((MK_MASK >> (k)) & 1) && lo <= (k) && (k) < hi)
#define SEAM(k) do { if (IN(k) && IN((k) + 1)) xcd_barrier(bar); } while (0)

    if (IN(0)) {
        LAS float* scr = (LAS float*)(lds + wave * 16384);
        const int gw = vcu * 8 + wave, NGW = G * 8;
        constexpr int I_IN = 16 * 144, I_XKV = 16 * 64, I_BA = 8 * 32, I_BS = 8 * 32, I_OUT = 16 * 32, I_XO = 4 * 4 * 32, I_FI = 16 * 176, I_FO = 44 * 32;
        constexpr int NIT = I_IN + I_XKV + I_BA + I_BS + I_OUT + I_XO + I_FI + I_FO;
        for (int it = gw; it < NIT; it += NGW) {
            int r = it;
            if (r < I_IN) { const int kb = r / 144, nb = r % 144; transpose_block(w_in, 1024, INC, WIN, 64 * kb, 32 * nb, 32 * nb, scr, lane); continue; } r -= I_IN;
            if (r < I_XKV) { const int kb = r / 64, nb = r % 64; transpose_block(w_xkv, 1024, 2048, WXKV, 64 * kb, 32 * nb, 32 * nb, scr, lane); continue; } r -= I_XKV;
            if (r < I_BA) { const int kb = r / 32, nb = r % 32; transpose_block(w_ba, 512, 1024, WA, 64 * kb, 32 * nb, 32 * nb, scr, lane); continue; } r -= I_BA;
            if (r < I_BS) { const int kb = r / 32, nb = r % 32; transpose_block(w_bs, 512, 1024, WB, 64 * kb, 32 * nb, 32 * nb, scr, lane); continue; } r -= I_BS;
            if (r < I_OUT) { const int kb = r / 32, nb = r % 32; transpose_block(w_out, 1024, 1024, WOUT, 64 * kb, 32 * nb, 32 * nb, scr, lane); continue; } r -= I_OUT;
            if (r < I_XO) { const int h = r / 128, q = r % 128, kb = q / 32, nb = q % 32;
                transpose_block(w_xo + (size_t)h * 256 * 1024, 256, 1024, WXOH + (size_t)h * 1024 * 256, 64 * kb, 32 * nb, 32 * nb, scr, lane); continue; } r -= I_XO;
            if (r < I_FI) { const int kb = r / 176, nb = r % 176; const int c0 = 32 * nb;
                const int isup = c0 >= DFF, cc = c0 - isup * DFF, drow = 256 * (cc / 128) + 128 * isup + (cc % 128);
                transpose_block(w_fi, 1024, 2 * DFF, WFI, 64 * kb, c0, drow, scr, lane); continue; } r -= I_FI;
            { const int kb = r / 32, nb = r % 32; transpose_block(w_fo, DFF, 1024, WFO, 64 * kb, 32 * nb, 32 * nb, scr, lane); }
        }
        for (int e = (vcu * 512 + tid) * 4; e < 1024 * 1024; e += G * 512 * 4) {
            const int d = e >> 10, cidx = e & 1023, h = cidx >> 8, j = cidx & 255;
            const f32x4 v = *(const f32x4*)(w_xq + e); u32x2 w; w.x = pk2(v.x, v.y); w.y = pk2(v.z, v.w);
            *(u32x2*)(WQH + ((size_t)h * 1024 + d) * 256 + j) = w;
        }
        for (int e = (vcu * 512 + tid) * 4; e < 8 * 128 * 128; e += G * 512 * 4) {
            const int s = e & 127, t = (e >> 7) & 127; const bool keep = (s >> 6) <= (t >> 6);
            const f32x4 v = *(const f32x4*)(sg_w + e); u32x2 w; w.x = keep ? pk2(v.x, v.y) : 0u; w.y = keep ? pk2(v.z, v.w) : 0u;
            *(u32x2*)(WSG + e) = w;
        }
        for (int m = gw; m < T; m += NGW) rms_row_to_bf16(x + (size_t)m * D, g_mix, XN + (size_t)m * D, lane);
        for (int m = gw; m < NB * ML; m += NGW) rms_row_to_bf16(mem + (size_t)m * D, g_mem, MEMN + (size_t)m * D, lane);
        LDS_WAIT();
    }
    SEAM(0);
    if (IN(1)) {
        SchedP1 S{G, bx, (const char*)XN, (const char*)WIN, (const char*)MEMN, (const char*)WXKV};
        EpiP1 E{Qb, Ub, GA, KH};
        pg8::gemm_phase(lds, 1024, S, E);
    }
    SEAM(1);
    if (IN(2)) {
        { SchedP2g S{bx, (const char*)KH, (const char*)VH, (const char*)WQH, (const char*)WXOH}; EpiStore E{WK, VW}; pg8::gemm_phase(lds, 256, S, E); }
        __syncthreads();
        for (int i = 0; i < 4; ++i) { const int idx = vcu * 4 + i; if (idx < 1024) att::unit(lds, idx >> 8, (idx >> 5) & 7, idx & 31, Qb, Kb, Vb, rel_bias, YA); }
        for (int i = 0; i < 8; ++i) { const int idx = vcu * 8 + i; if (idx < 2048) sgu::unit(lds, idx >> 9, (idx >> 3) & 63, idx & 7, Ub, VSb, ln_g, ln_b, WSG, sg_b, YS); }
    }
    SEAM(2);
    if (IN(3)) {
        SchedP3 S{G, bx, (const char*)YA, (const char*)YS, (const char*)WA, (const char*)WB};
        EpiMerge E{GA, GB, MG};
        pg8::gemm_phase(lds, 512, S, E);
    }
    SEAM(3);
    if (IN(4)) {
        SchedN4 S{G, bx, (const char*)MG, (const char*)WOUT, 524288, 524288, 0};
        EpiX<true> E{x, out, XG1, g_xa, SSQ1};
        pg8::gemm_phase(lds, 1024, S, E);
    }
    SEAM(4);
    if (IN(5)) {
        SchedN4 S{G, bx, (const char*)XG1, (const char*)WK, 524288, 524288, 2097152};
        fill_rstd(S, SSQ1, lds);
        EpiSoftmax E{PP, lds};
        pg8::gemm_phase(lds, 1024, S, E);
    }
    SEAM(5);
    if (IN(6)) {
        SchedN4 S{G, bx, (const char*)PP, (const char*)VW, 524288, 524288, 2097152};
        EpiX<true> E{out, out, XG2, g_ffn, SSQ2};
        pg8::gemm_phase(lds, 1024, S, E);
    }
    SEAM(6);
    if (IN(7)) {
        SchedP7 S{G, bx, (const char*)XG2, (const char*)WFI};
        fill_rstd(S, SSQ2, lds);
        EpiSwiglu E{HB, lds};
        pg8::gemm_phase(lds, 1024, S, E);
    }
    SEAM(7);
    if (IN(8)) {
        SchedN4 S{G, bx, (const char*)HB, (const char*)WFO, (size_t)256 * DFF * 2, (size_t)256 * DFF * 2, 0};
        EpiX<false> E{out, out, nullptr, nullptr, SSQ3};
        pg8::gemm_phase(lds, DFF, S, E);
    }
    SEAM(8);
    if (IN(9)) {
        const int gw = vcu * 8 + wave, NGW = G * 8;
        for (int m = gw; m < T; m += NGW) {
            const f32x4* p = (const f32x4*)(SSQ3 + (size_t)m * 16);
            const f32x4 a = p[0], b = p[1], c = p[2], d = p[3];
            const float s = ((a[0] + a[1]) + (a[2] + a[3])) + ((b[0] + b[1]) + (b[2] + b[3])) + ((c[0] + c[1]) + (c[2] + c[3])) + ((d[0] + d[1]) + (d[2] + d[3]));
            const float rstd = 1.0f / sqrtf(s * (1.f / D) + EPS);
            f32x4* xr = (f32x4*)(out + (size_t)m * D) + lane; const f32x4* gr = (const f32x4*)g_fin + lane;
#pragma unroll
            for (int j = 0; j < 4; ++j) { const f32x4 v = xr[64 * j]; xr[64 * j] = v * rstd * gr[64 * j]; }
        }
    }
#undef IN
#undef SEAM
}

extern "C" void kernel_launch(void* const* d_in, const int* in_sizes, int n_in, void* d_out, int out_size, void* d_ws, size_t ws_size, hipStream_t stream) {
    static int grid = 0;
    if (grid == 0) {
        if (n_in != 21 || out_size != T * D || ws_size < WS_END) { fprintf(stderr, "kernel_launch: unexpected shapes (n_in %d, out %d, ws %zu)\n", n_in, out_size, ws_size); grid = -1; return; }
        int dev = 0, cus = 0, per_cu = 0;
        if (hipGetDevice(&dev) != hipSuccess || hipDeviceGetAttribute(&cus, hipDeviceAttributeMultiprocessorCount, dev) != hipSuccess) { grid = -1; return; }
        if (hipFuncSetAttribute((const void*)mk_fwd, hipFuncAttributeMaxDynamicSharedMemorySize, LDS_BYTES) != hipSuccess) { fprintf(stderr, "kernel_launch: hipFuncSetAttribute failed\n"); grid = -1; return; }
        if (hipOccupancyMaxActiveBlocksPerMultiprocessor(&per_cu, (const void*)mk_fwd, 512, LDS_BYTES) != hipSuccess || per_cu < 1) { fprintf(stderr, "kernel_launch: occupancy query says %d\n", per_cu); per_cu = 1; }
        (void)hipGetLastError();
        grid = cus;
    }
    if (grid < 0) return;
    if (hipMemsetAsync((char*)d_ws + WS_CTL, 0, CTL_ZERO_BYTES, stream) != hipSuccess) return;
    Args a{};
    for (int i = 0; i < 21; ++i) a.in[i] = (const float*)d_in[i];
    a.out = (float*)d_out; a.ws = (unsigned char*)d_ws;
#if MK_PER_PHASE
    for (int p = 0; p < NPHASE; ++p) { a.ph_lo = p; a.ph_hi = p + 1; hipLaunchKernelGGL(mk_fwd, dim3(grid), dim3(512), LDS_BYTES, stream, a); }
#else
    a.ph_lo = 0; a.ph_hi = NPHASE;
    hipLaunchKernelGGL(mk_fwd, dim3(grid), dim3(512), LDS_BYTES, stream, a);
#endif
}
```
